# Optimizing an MI355X kernel written in HIP

```python
import jax, jax.numpy as jnp
from jax import lax
import numpy as np

D_MODEL = 1024
BATCH = 16
SEQ = 2048
DEPTH = 1

ATT_HEADS = 8
ATT_KV_HEADS = 2
ATT_HEAD_DIM = 64
ATT_WIDTH = ATT_HEADS * ATT_HEAD_DIM
ATT_KV_WIDTH = ATT_KV_HEADS * ATT_HEAD_DIM
WINDOW = 128
ATT_BLOCK = 128
ROPE_THETA = 500000.0
ROT_DIM = ATT_HEAD_DIM // 4
ML_HEADS = 4
ML_QK_DIM = 64
ML_V_DIM = 128
ML_QK_WIDTH = ML_HEADS * ML_QK_DIM
ML_WIDTH = ML_HEADS * ML_V_DIM
ML_CHUNK = 64
GATE_CAP = 15.0
D_FF = ((8 * D_MODEL // 3 + 255) // 256) * 256
N_BRANCH = 2
EPS = 1e-6
IN_SIZES = (ATT_WIDTH, ATT_KV_WIDTH, ATT_KV_WIDTH,
            ML_QK_WIDTH, ML_QK_WIDTH, ML_WIDTH, ML_WIDTH,
            2 * ML_HEADS,
            N_BRANCH * D_MODEL)
IN_WIDTH = sum(IN_SIZES)

kernel_name = "hybrid_swa_sink_mlstm_gated_block"


def rmsnorm(x, g):
    xf = x.astype(jnp.float32)
    y = xf * lax.rsqrt(jnp.mean(xf * xf, axis=-1, keepdims=True) + EPS)
    return (y * g.astype(jnp.float32)).astype(x.dtype)


def rope_tables(positions):
    inv_freq = ROPE_THETA ** (-jnp.arange(0, ROT_DIM, 2, dtype=jnp.float32) / ROT_DIM)
    ang = positions.astype(jnp.float32)[..., None] * inv_freq
    return jnp.cos(ang)[:, :, None, :], jnp.sin(ang)[:, :, None, :]


def apply_partial_rope(x, cos, sin):
    half = ROT_DIM // 2
    xf = x.astype(jnp.float32)
    x1, x2, rest = xf[..., :half], xf[..., half:ROT_DIM], xf[..., ROT_DIM:]
    rot = jnp.concatenate([x1 * cos - x2 * sin, x2 * cos + x1 * sin, rest], axis=-1)
    return rot.astype(x.dtype)


def sliding_window_attention(q, k, v, sinks):
    B, S, Hq, hd = q.shape
    G = Hq // ATT_KV_HEADS
    nb = S // ATT_BLOCK
    qb = q.reshape(B, nb, ATT_BLOCK, ATT_KV_HEADS, G, hd)

    def band(a):
        ap = jnp.pad(a, ((0, 0), (ATT_BLOCK, 0), (0, 0), (0, 0)))
        ap = ap.reshape(B, nb + 1, ATT_BLOCK, ATT_KV_HEADS, hd)
        return jnp.concatenate([ap[:, :-1], ap[:, 1:]], axis=2)

    kb, vb = band(k), band(v)
    scores = jnp.einsum('bnqhgd,bnkhd->bnhgqk', qb, kb).astype(jnp.float32) * (hd ** -0.5)
    qi = jnp.arange(ATT_BLOCK)[:, None]
    kj = jnp.arange(2 * ATT_BLOCK)[None, :]
    rel = qi - kj + ATT_BLOCK
    in_window = (rel >= 0) & (rel < WINDOW)
    key_pos = jnp.arange(nb)[:, None, None] * ATT_BLOCK + kj[None] - ATT_BLOCK
    mask = in_window[None] & (key_pos >= 0)
    scores = jnp.where(mask[None, :, None, None], scores, -jnp.inf)
    sink = sinks.astype(jnp.float32).reshape(ATT_KV_HEADS, G)[None, None, :, :, None, None]
    m = jnp.maximum(scores.max(axis=-1, keepdims=True), sink)
    p = jnp.exp(scores - m)
    denom = p.sum(axis=-1, keepdims=True) + jnp.exp(sink - m)
    probs = (p / denom).astype(v.dtype)
    out = jnp.einsum('bnhgqk,bnkhd->bnqhgd', probs, vb)
    return out.reshape(B, S, Hq * hd)


def mlstm_chunkwise(q, k, v, i_pre, f_pre):
    B, S, H, dqk = q.shape
    dv = v.shape[-1]
    nc = S // ML_CHUNK
    f32 = jnp.float32
    q = q.astype(f32) * (dqk ** -0.5)
    k = k.astype(f32)
    v = v.astype(f32)
    i_log = GATE_CAP * jnp.tanh(i_pre.astype(f32) / GATE_CAP)
    f_log = jax.nn.log_sigmoid(GATE_CAP * jnp.tanh(f_pre.astype(f32) / GATE_CAP))

    def chunk4(a):
        return a.reshape(B, nc, ML_CHUNK, H, a.shape[-1]).transpose(1, 0, 3, 2, 4)

    def chunk3(a):
        return a.reshape(B, nc, ML_CHUNK, H).transpose(1, 0, 3, 2)

    causal = jnp.tril(jnp.ones((ML_CHUNK, ML_CHUNK), dtype=bool))

    def body(carry, xs):
        C, n, m = carry
        qc, kc, vc, ic, fc = xs
        b = jnp.cumsum(fc, axis=-1)
        Dm = jnp.where(causal, b[..., :, None] - b[..., None, :] + ic[..., None, :], -jnp.inf)
        inter = b + m[..., None]
        m_t = jnp.maximum(inter, Dm.max(axis=-1))
        w_intra = jnp.exp(Dm - m_t[..., None]) * jnp.einsum('bhtd,bhsd->bhts', qc, kc)
        w_inter = jnp.exp(inter - m_t)
        num = (jnp.einsum('bhts,bhsv->bhtv', w_intra, vc)
               + w_inter[..., None] * jnp.einsum('bhtd,bhdv->bhtv', qc, C))
        den = w_intra.sum(axis=-1) + w_inter * jnp.einsum('bhtd,bhd->bht', qc, n)
        h = num / jnp.maximum(jnp.abs(den), jnp.exp(-m_t))[..., None]
        b_last = b[..., -1]
        g = b_last[..., None] - b + ic
        m_new = jnp.maximum(b_last + m, g.max(axis=-1))
        decay = jnp.exp(b_last + m - m_new)
        wk = jnp.exp(g - m_new[..., None])
        C_new = decay[..., None, None] * C + jnp.einsum('bhs,bhsd,bhsv->bhdv', wk, kc, vc)
        n_new = decay[..., None] * n + jnp.einsum('bhs,bhsd->bhd', wk, kc)
        return (C_new, n_new, m_new), h

    init = (jnp.zeros((B, H, dqk, dv), f32), jnp.zeros((B, H, dqk), f32), jnp.zeros((B, H), f32))
    _, hs = lax.scan(body, init, (chunk4(q), chunk4(k), chunk4(v), chunk3(i_log), chunk3(f_log)))
    return hs.transpose(1, 0, 3, 2, 4).reshape(B, S, H, dv)


def setup_inputs(seed: int = 0) -> dict:
    key = jax.random.key(seed)
    ks = jax.random.split(key, 24)
    L = DEPTH

    def w(k, shape, fan_in):
        return jax.random.normal(k, shape, jnp.float32) * fan_in ** -0.5

    def gain(k, shape):
        return 1.0 + 0.05 * jax.random.normal(k, shape, jnp.float32)

    x = jax.random.normal(ks[0], (BATCH, SEQ, D_MODEL), jnp.float32)
    c = jax.random.normal(ks[1], (BATCH, D_MODEL), jnp.float32)
    offset = jax.random.randint(ks[2], (BATCH, 1), 0, 1024, dtype=jnp.int32)
    positions = offset + jnp.arange(SEQ, dtype=jnp.int32)[None, :]
    f_bias = jnp.linspace(3.0, 6.0, ML_HEADS, dtype=jnp.float32)[None, :] + 0.1 * jax.random.normal(ks[3], (L, ML_HEADS), jnp.float32)
    i_bias = 0.1 * jax.random.normal(ks[4], (L, ML_HEADS), jnp.float32)
    return {
        "x": x,
        "c": c,
        "positions": positions,
        "w_ada": w(ks[5], (L, D_MODEL, 6 * D_MODEL), D_MODEL),
        "b_ada": 0.02 * jax.random.normal(ks[6], (L, 6 * D_MODEL), jnp.float32),
        "g_pre_mix": gain(ks[7], (L, D_MODEL)),
        "w_in": w(ks[8], (L, D_MODEL, IN_WIDTH), D_MODEL),
        "b_mlstm_gates": jnp.concatenate([i_bias, f_bias], axis=-1),
        "sinks": 0.5 * jax.random.normal(ks[9], (L, ATT_HEADS), jnp.float32),
        "g_mlstm_norm": gain(ks[10], (L, ML_WIDTH)),
        "w_att_o": w(ks[11], (L, ATT_WIDTH, D_MODEL), ATT_WIDTH),
        "w_ml_o": w(ks[12], (L, ML_WIDTH, D_MODEL), ML_WIDTH),
        "w_out": w(ks[13], (L, D_MODEL, D_MODEL), D_MODEL),
        "g_post_mix": gain(ks[14], (L, D_MODEL)),
        "g_pre_ffn": gain(ks[15], (L, D_MODEL)),
        "w_ffn_in": w(ks[16], (L, D_MODEL, 2 * D_FF), D_MODEL),
        "w_ffn_out": w(ks[17], (L, D_FF, D_MODEL), D_FF),
        "g_post_ffn": gain(ks[18], (L, D_MODEL)),
    }


def reference(x, c, positions, w_ada, b_ada, g_pre_mix, w_in, b_mlstm_gates, sinks,
              g_mlstm_norm, w_att_o, w_ml_o, w_out, g_post_mix, g_pre_ffn, w_ffn_in,
              w_ffn_out, g_post_ffn):
    B, S, _ = x.shape
    cos, sin = rope_tables(positions)
    c_act = jax.nn.silu(c)
    split_idx = [int(v) for v in np.cumsum(IN_SIZES)[:-1]]
    for l in range(DEPTH):
        ada = c_act @ w_ada[l] + b_ada[l]
        shift1, scale1, gate1, shift2, scale2, gate2 = [a[:, None, :] for a in jnp.split(ada, 6, axis=-1)]

        h = rmsnorm(x, g_pre_mix[l]) * (1.0 + scale1) + shift1
        proj = h @ w_in[l]
        qa, ka, va, qm, km, vm, om, ifm, gates = jnp.split(proj, split_idx, axis=-1)

        qa = apply_partial_rope(qa.reshape(B, S, ATT_HEADS, ATT_HEAD_DIM), cos, sin)
        ka = apply_partial_rope(ka.reshape(B, S, ATT_KV_HEADS, ATT_HEAD_DIM), cos, sin)
        va = va.reshape(B, S, ATT_KV_HEADS, ATT_HEAD_DIM)
        att = sliding_window_attention(qa, ka, va, sinks[l])

        ifm = ifm + b_mlstm_gates[l]
        hm = mlstm_chunkwise(qm.reshape(B, S, ML_HEADS, ML_QK_DIM),
                             km.reshape(B, S, ML_HEADS, ML_QK_DIM),
                             vm.reshape(B, S, ML_HEADS, ML_V_DIM),
                             ifm[..., :ML_HEADS], ifm[..., ML_HEADS:])
        hm = hm * lax.rsqrt(jnp.mean(hm * hm, axis=-1, keepdims=True) + EPS)
        hm = hm.reshape(B, S, ML_WIDTH).astype(x.dtype) * g_mlstm_norm[l]
        ml = jax.nn.sigmoid(om) * hm

        g_att, g_ml = jnp.split(jax.nn.sigmoid(gates), N_BRANCH, axis=-1)
        merged = g_att * (att @ w_att_o[l]) + g_ml * (ml @ w_ml_o[l])
        mix = merged @ w_out[l]
        x = x + gate1 * rmsnorm(mix, g_post_mix[l])

        h2 = rmsnorm(x, g_pre_ffn[l]) * (1.0 + scale2) + shift2
        f_gate, f_up = jnp.split(h2 @ w_ffn_in[l], 2, axis=-1)
        ffn = (jax.nn.silu(f_gate) * f_up) @ w_ffn_out[l]
        x = x + gate2 * rmsnorm(ffn, g_post_ffn[l])
    return x
```

```cpp
#include <hip/hip_runtime.h>
#include <cstdint>
#include <cstdio>

typedef unsigned short bf16_t;
constexpr int NB = 16, NS = 2048, DM = 1024, M = NB * NS;
constexpr int INW = 4360, DFF = 2816;
constexpr float QSCALE = 0.18033688011112042f;
constexpr float LOG2E = 1.4426950408889634f;
constexpr size_t MiB = 1u << 20;
constexpr size_t WS_CTL = 0;
constexpr size_t WS_ADA = 1 * MiB;
constexpr size_t WS_ROPE = 2 * MiB;
constexpr size_t WS_IL = 4 * MiB;
constexpr size_t WS_FL = 4 * MiB + 512 * 1024;
constexpr size_t WS_XN = 40 * MiB;
constexpr size_t WS_QA = 104 * MiB;
constexpr size_t WS_KA = 136 * MiB;
constexpr size_t WS_VAT = 144 * MiB;
constexpr size_t WS_QM = 152 * MiB;
constexpr size_t WS_MERGED = 104 * MiB;
constexpr size_t WS_KM = 168 * MiB;
constexpr size_t WS_KMT = 184 * MiB;
constexpr size_t WS_VMT = 200 * MiB;
constexpr size_t WS_OMS = 232 * MiB;
constexpr size_t WS_GR = 264 * MiB;
constexpr size_t WS_GM = 328 * MiB;
constexpr size_t WS_AM = 392 * MiB;
constexpr size_t WS_ACT = 104 * MiB;
constexpr size_t WS_TMP2 = 280 * MiB;
constexpr size_t WS_END = 488 * MiB;

__device__ __forceinline__ bf16_t f2bf(float f) { unsigned u = __float_as_uint(f); u += 0x7fffu + ((u >> 16) & 1u); return (bf16_t)(u >> 16); }
__device__ __forceinline__ float bf2f(bf16_t h) { return __uint_as_float(((unsigned)h) << 16); }
__device__ __forceinline__ float wave_sum(float v) {
#pragma unroll
    for (int o = 1; o < 64; o <<= 1) v += __shfl_xor(v, o);
    return v;
}
__device__ __forceinline__ float wave_max(float v) {
#pragma unroll
    for (int o = 1; o < 64; o <<= 1) v = fmaxf(v, __shfl_xor(v, o));
    return v;
}
__device__ __forceinline__ float sigmoidf_(float v) { return 1.f / (1.f + expf(-v)); }

namespace nv {
__global__ __launch_bounds__(256) void gemm(const bf16_t* __restrict__ A, int lda, const float* __restrict__ Bm, int ldb, float* __restrict__ C, int ldc, int N, int K) {
    __shared__ float As[16][68];
    __shared__ float Bs[16][68];
    const int tx = threadIdx.x & 15, ty = threadIdx.x >> 4;
    const int m0 = blockIdx.y * 64, n0 = blockIdx.x * 64;
    float acc[4][4];
#pragma unroll
    for (int i = 0; i < 4; ++i)
#pragma unroll
        for (int j = 0; j < 4; ++j) acc[i][j] = 0.f;
    for (int k0 = 0; k0 < K; k0 += 16) {
#pragma unroll
        for (int q = 0; q < 4; ++q) { const int i = threadIdx.x + q * 256; const int r = i >> 4, kk = i & 15; As[kk][r] = bf2f(A[(size_t)(m0 + r) * lda + k0 + kk]); }
#pragma unroll
        for (int q = 0; q < 4; ++q) { const int i = threadIdx.x + q * 256; const int kk = i >> 6, c = i & 63; const int n = n0 + c; Bs[kk][c] = n < N ? Bm[(size_t)(k0 + kk) * ldb + n] : 0.f; }
        __syncthreads();
#pragma unroll
        for (int kk = 0; kk < 16; ++kk) {
            float a[4], b[4];
#pragma unroll
            for (int i = 0; i < 4; ++i) a[i] = As[kk][ty * 4 + i];
#pragma unroll
            for (int j = 0; j < 4; ++j) b[j] = Bs[kk][tx * 4 + j];
#pragma unroll
            for (int i = 0; i < 4; ++i)
#pragma unroll
                for (int j = 0; j < 4; ++j) acc[i][j] += a[i] * b[j];
        }
        __syncthreads();
    }
#pragma unroll
    for (int i = 0; i < 4; ++i)
#pragma unroll
        for (int j = 0; j < 4; ++j) { const int n = n0 + tx * 4 + j; if (n < N) C[(size_t)(m0 + ty * 4 + i) * ldc + n] = acc[i][j]; }
}

__global__ __launch_bounds__(256) void ada(const float* __restrict__ c, const float* __restrict__ w_ada, const float* __restrict__ b_ada, float* __restrict__ out) {
    const int j = blockIdx.x * 256 + threadIdx.x, b = blockIdx.y;
    float acc = 0.f;
    for (int k = 0; k < 1024; ++k) { const float cv = c[b * 1024 + k]; acc += (cv * sigmoidf_(cv)) * w_ada[(size_t)k * 6144 + j]; }
    out[b * 6144 + j] = acc + b_ada[j];
}

__global__ __launch_bounds__(256) void rowprep(const float* __restrict__ x, const int* __restrict__ pos, const float* __restrict__ ada, const float* __restrict__ g_pre, const float* __restrict__ w_in,
                                               const float* __restrict__ b_gates, bf16_t* __restrict__ XN, float* __restrict__ IL, float* __restrict__ FL, float* __restrict__ ROPE) {
    const int m = blockIdx.x, b = m >> 11, t = m & 2047, tid = threadIdx.x;
    __shared__ float red[4]; __shared__ float hrow[1024]; __shared__ float part[256];
    const float4 xv = ((const float4*)(x + (size_t)m * 1024))[tid];
    float ss = wave_sum(xv.x * xv.x + xv.y * xv.y + xv.z * xv.z + xv.w * xv.w);
    if ((tid & 63) == 0) red[tid >> 6] = ss;
    __syncthreads();
    const float rs = rsqrtf((red[0] + red[1] + red[2] + red[3]) * (1.f / 1024.f) + 1e-6f);
    const float xa[4] = {xv.x, xv.y, xv.z, xv.w};
#pragma unroll
    for (int e = 0; e < 4; ++e) { const int k = tid * 4 + e; const float h = xa[e] * rs * g_pre[k] * (1.f + ada[b * 6144 + 1024 + k]) + ada[b * 6144 + k]; hrow[k] = h; XN[(size_t)m * 1024 + k] = f2bf(h); }
    __syncthreads();
    { const int j = tid & 7, kp = tid >> 3; float p = 0.f; for (int kk = 0; kk < 32; ++kk) { const int k = kp * 32 + kk; p += hrow[k] * w_in[(size_t)k * INW + 2304 + j]; } part[tid] = p; }
    __syncthreads();
    if (tid < 8) {
        float s = 0.f; for (int q = 0; q < 32; ++q) s += part[q * 8 + tid];
        s += b_gates[tid];
        const float v = 15.f * tanhf(s * (1.f / 15.f)); const int hh = tid & 3;
        if (tid < 4) IL[(size_t)(b * 4 + hh) * 2048 + t] = v;
        else FL[(size_t)(b * 4 + hh) * 2048 + t] = fminf(v, 0.f) - log1pf(expf(-fabsf(v)));
    } else if (tid >= 64 && tid < 72) {
        const int i = tid - 64;
        const float invf[8] = {1.0000000e+00f, 1.9392274e-01f, 3.7606031e-02f, 7.2926646e-03f, 1.4142136e-03f, 2.7424819e-04f, 5.3182961e-05f, 1.0313386e-05f};
        float fr = 1.f;
#pragma unroll
        for (int q = 0; q < 8; ++q) fr = (i == q) ? invf[q] : fr;
        const float ang = (float)pos[m] * fr;
        double r = (double)ang * 0.15915494309189535; r -= rint(r);
        ROPE[(size_t)m * 16 + i] = __builtin_amdgcn_cosf((float)r); ROPE[(size_t)m * 16 + 8 + i] = __builtin_amdgcn_sinf((float)r);
    }
}

__global__ __launch_bounds__(256) void proj_epi(const float* __restrict__ T, int row0, int nrows, const float* __restrict__ ROPE, bf16_t* QA, bf16_t* KA, bf16_t* VAT, bf16_t* QM, bf16_t* KM, bf16_t* KMT, bf16_t* VMT, bf16_t* OMS, bf16_t* GR, bf16_t* GM) {
    const size_t idx = (size_t)blockIdx.x * 256 + threadIdx.x; if (idx >= (size_t)nrows * INW) return;
    const int r = (int)(idx / INW), j = (int)(idx % INW); const size_t m = (size_t)row0 + r;
    const float* Tr = T + (size_t)r * INW; float v = Tr[j];
    if (j < 640) {
        const int d = j & 63;
        if (d < 16) { const int i = d & 7; const float c = ROPE[m * 16 + i], s = ROPE[m * 16 + 8 + i]; const float x1 = Tr[j - d + i], x2 = Tr[j - d + 8 + i]; v = d < 8 ? x1 * c - x2 * s : x2 * c + x1 * s; }
        if (j < 512) QA[m * 512 + j] = f2bf(v * QSCALE); else KA[m * 128 + (j - 512)] = f2bf(v);
    } else if (j < 768) VAT[(size_t)(j - 640) * M + m] = f2bf(v);
    else if (j < 1024) QM[m * 256 + (j - 768)] = f2bf(v * 0.125f);
    else if (j < 1280) { KM[m * 256 + (j - 1024)] = f2bf(v); KMT[(size_t)(j - 1024) * M + m] = f2bf(v); }
    else if (j < 1792) VMT[(size_t)(j - 1280) * M + m] = f2bf(v);
    else if (j < 2304) OMS[m * 512 + (j - 1792)] = f2bf(sigmoidf_(v));
    else if (j < 2312) {}
    else if (j < 3336) { const int c = j - 2312; const float a = v, bb = Tr[j + 1024]; GR[m * 1024 + c] = f2bf((1.f + expf(-bb)) / (1.f + expf(-a))); GM[m * 1024 + c] = f2bf(sigmoidf_(bb)); }
}

__global__ __launch_bounds__(256) void attn(const bf16_t* __restrict__ QA, const bf16_t* __restrict__ KA, const bf16_t* __restrict__ VAT, const float* __restrict__ sinks, bf16_t* __restrict__ AM) {
    const int gw = blockIdx.x * 4 + (threadIdx.x >> 6), lane = threadIdx.x & 63;
    const int hq = gw & 7, m = gw >> 3, b = m >> 11, t = m & 2047, kvh = hq >> 2;
    const float sink2 = sinks[hq] * LOG2E;
    float sc[2]; int ss[2];
#pragma unroll
    for (int j = 0; j < 2; ++j) {
        const int s = t - 127 + lane + 64 * j; ss[j] = s < 0 ? 0 : s;
        float dot = 0.f;
        const bf16_t* qp = QA + (size_t)m * 512 + hq * 64; const bf16_t* kp = KA + (size_t)(b * 2048 + ss[j]) * 128 + kvh * 64;
        for (int d = 0; d < 64; ++d) dot += bf2f(qp[d]) * bf2f(kp[d]);
        sc[j] = s >= 0 ? dot : -INFINITY;
    }
    const float mx = fmaxf(wave_max(fmaxf(sc[0], sc[1])), sink2);
    const float p0 = exp2f(sc[0] - mx), p1 = exp2f(sc[1] - mx);
    const float den = wave_sum(p0 + p1) + exp2f(sink2 - mx);
    float o = 0.f; const bf16_t* vp = VAT + (size_t)(kvh * 64 + lane) * M + (size_t)b * 2048;
    for (int l = 0; l < 64; ++l) { const float a = __shfl(p0, l), c = __shfl(p1, l); const int s0 = __shfl(ss[0], l), s1 = __shfl(ss[1], l); o += a * bf2f(vp[s0]) + c * bf2f(vp[s1]); }
    AM[(size_t)m * 1024 + hq * 64 + lane] = f2bf(o / den);
}

__global__ __launch_bounds__(128) void mlstm(const bf16_t* __restrict__ QM, const bf16_t* __restrict__ KM, const bf16_t* __restrict__ VMT, const float* __restrict__ IL, const float* __restrict__ FL,
                                             const bf16_t* __restrict__ OMS, const float* __restrict__ g_norm, bf16_t* __restrict__ AM) {
    const int bh = blockIdx.x, b = bh >> 2, h = bh & 3, v = threadIdx.x;
    float C[64], n[64];
#pragma unroll
    for (int d = 0; d < 64; ++d) { C[d] = 0.f; n[d] = 0.f; }
    float ms = 0.f; const float gn = g_norm[h * 128 + v];
    __shared__ float sq[64], sk[64], red[2];
    for (int t = 0; t < 2048; ++t) {
        const size_t m = (size_t)b * 2048 + t;
        if (v < 64) { sq[v] = bf2f(QM[m * 256 + h * 64 + v]); sk[v] = bf2f(KM[m * 256 + h * 64 + v]); }
        __syncthreads();
        const float il = IL[(size_t)bh * 2048 + t], fl = FL[(size_t)bh * 2048 + t], vv = bf2f(VMT[(size_t)(h * 128 + v) * M + m]);
        const float mn = fmaxf(fl + ms, il), a = expf(fl + ms - mn), bi = expf(il - mn); ms = mn;
        float num = 0.f, den = 0.f;
#pragma unroll
        for (int d = 0; d < 64; ++d) { const float kk = bi * sk[d]; C[d] = a * C[d] + kk * vv; n[d] = a * n[d] + kk; num += sq[d] * C[d]; den += sq[d] * n[d]; }
        const float hv = num / fmaxf(fabsf(den), expf(-mn));
        const float s2 = wave_sum(hv * hv); if ((v & 63) == 0) red[v >> 6] = s2;
        __syncthreads();
        const float hn = hv * rsqrtf((red[0] + red[1]) * (1.f / 128.f) + 1e-6f) * gn;
        AM[m * 1024 + 512 + h * 128 + v] = f2bf(bf2f(OMS[m * 512 + h * 128 + v]) * hn);
    }
}

__global__ __launch_bounds__(256) void merge_epi(const float* __restrict__ T1, const float* __restrict__ T2, int row0, int nrows, const bf16_t* __restrict__ GR, const bf16_t* __restrict__ GM, bf16_t* __restrict__ MERGED) {
    const size_t idx = (size_t)blockIdx.x * 256 + threadIdx.x; if (idx >= (size_t)nrows * 1024) return;
    const size_t g = (size_t)row0 * 1024 + idx;
    MERGED[g] = f2bf(bf2f(GM[g]) * (bf2f(GR[g]) * T1[idx] + T2[idx]));
}

__device__ __forceinline__ float block_sum256(float v, float* red) {
    v = wave_sum(v); __syncthreads(); if ((threadIdx.x & 63) == 0) red[threadIdx.x >> 6] = v; __syncthreads(); return red[0] + red[1] + red[2] + red[3];
}
__global__ __launch_bounds__(256) void postmix(const float* __restrict__ x, float* OUT, const float* __restrict__ ada, const float* __restrict__ g_post, const float* __restrict__ g_pre2, bf16_t* __restrict__ XN) {
    const int m = blockIdx.x, b = m >> 11, tid = threadIdx.x; __shared__ float red[4];
    const float4 mv = ((const float4*)(OUT + (size_t)m * 1024))[tid]; const float4 xv = ((const float4*)(x + (size_t)m * 1024))[tid];
    const float rs = rsqrtf(block_sum256(mv.x * mv.x + mv.y * mv.y + mv.z * mv.z + mv.w * mv.w, red) * (1.f / 1024.f) + 1e-6f);
    const float ma[4] = {mv.x, mv.y, mv.z, mv.w}, xa[4] = {xv.x, xv.y, xv.z, xv.w}; float x1[4]; float ss = 0.f;
#pragma unroll
    for (int e = 0; e < 4; ++e) { const int k = tid * 4 + e; x1[e] = xa[e] + ada[b * 6144 + 2048 + k] * (ma[e] * rs * g_post[k]); ss += x1[e] * x1[e]; }
    const float rs2 = rsqrtf(block_sum256(ss, red) * (1.f / 1024.f) + 1e-6f);
    ((float4*)(OUT + (size_t)m * 1024))[tid] = make_float4(x1[0], x1[1], x1[2], x1[3]);
#pragma unroll
    for (int e = 0; e < 4; ++e) { const int k = tid * 4 + e; XN[(size_t)m * 1024 + k] = f2bf(x1[e] * rs2 * g_pre2[k] * (1.f + ada[b * 6144 + 4096 + k]) + ada[b * 6144 + 3072 + k]); }
}
__global__ __launch_bounds__(256) void ffn_act(const float* __restrict__ T, int row0, int nrows, bf16_t* __restrict__ ACT) {
    const size_t idx = (size_t)blockIdx.x * 256 + threadIdx.x; if (idx >= (size_t)nrows * DFF) return;
    const int r = (int)(idx / DFF), j = (int)(idx % DFF); const float g = T[(size_t)r * 2 * DFF + j], u = T[(size_t)r * 2 * DFF + DFF + j];
    ACT[(size_t)(row0 + r) * DFF + j] = f2bf(g * sigmoidf_(g) * u);
}
__global__ __launch_bounds__(256) void final_row(const float* __restrict__ F, float* OUT, const float* __restrict__ ada, const float* __restrict__ g_post) {
    const int m = blockIdx.x, b = m >> 11, tid = threadIdx.x; __shared__ float red[4];
    const float4 fv = ((const float4*)(F + (size_t)m * 1024))[tid]; const float4 xv = ((const float4*)(OUT + (size_t)m * 1024))[tid];
    const float rs = rsqrtf(block_sum256(fv.x * fv.x + fv.y * fv.y + fv.z * fv.z + fv.w * fv.w, red) * (1.f / 1024.f) + 1e-6f);
    const float fa[4] = {fv.x, fv.y, fv.z, fv.w}, xa[4] = {xv.x, xv.y, xv.z, xv.w}; float o[4];
#pragma unroll
    for (int e = 0; e < 4; ++e) { const int k = tid * 4 + e; o[e] = xa[e] + ada[b * 6144 + 5120 + k] * (fa[e] * rs * g_post[k]); }
    ((float4*)(OUT + (size_t)m * 1024))[tid] = make_float4(o[0], o[1], o[2], o[3]);
}
}

extern "C" void kernel_launch(void* const* d_in, const int* in_sizes, int n_in, void* d_out, int out_size, void* d_ws, size_t ws_size, hipStream_t stream) {
    if (n_in != 18 || in_sizes[0] != M * DM || out_size != M * DM || ws_size < WS_END) { fprintf(stderr, "kernel_launch: unexpected shapes n_in %d in0 %d out %d ws %zu\n", n_in, n_in > 0 ? in_sizes[0] : -1, out_size, ws_size); return; }
    const float* x = (const float*)d_in[0]; const float* c = (const float*)d_in[1]; const int* pos = (const int*)d_in[2];
    const float* w_ada = (const float*)d_in[3]; const float* b_ada = (const float*)d_in[4]; const float* g_pre_mix = (const float*)d_in[5];
    const float* w_in = (const float*)d_in[6]; const float* b_gates = (const float*)d_in[7]; const float* sinks = (const float*)d_in[8];
    const float* g_mlstm = (const float*)d_in[9]; const float* w_att_o = (const float*)d_in[10]; const float* w_ml_o = (const float*)d_in[11];
    const float* w_out = (const float*)d_in[12]; const float* g_post_mix = (const float*)d_in[13]; const float* g_pre_ffn = (const float*)d_in[14];
    const float* w_ffn_in = (const float*)d_in[15]; const float* w_ffn_out = (const float*)d_in[16]; const float* g_post_ffn = (const float*)d_in[17];
    unsigned char* ws = (unsigned char*)d_ws; float* out = (float*)d_out;
    float* ADA = (float*)(ws + WS_ADA); float* ROPE = (float*)(ws + WS_ROPE); float* IL = (float*)(ws + WS_IL); float* FL = (float*)(ws + WS_FL);
    bf16_t* XN = (bf16_t*)(ws + WS_XN); bf16_t* QA = (bf16_t*)(ws + WS_QA); bf16_t* KA = (bf16_t*)(ws + WS_KA); bf16_t* VAT = (bf16_t*)(ws + WS_VAT);
    bf16_t* QM = (bf16_t*)(ws + WS_QM); bf16_t* KM = (bf16_t*)(ws + WS_KM); bf16_t* KMT = (bf16_t*)(ws + WS_KMT); bf16_t* VMT = (bf16_t*)(ws + WS_VMT);
    bf16_t* OMS = (bf16_t*)(ws + WS_OMS); bf16_t* GR = (bf16_t*)(ws + WS_GR); bf16_t* GM = (bf16_t*)(ws + WS_GM); bf16_t* AM = (bf16_t*)(ws + WS_AM);
    bf16_t* MERGED = (bf16_t*)(ws + WS_MERGED); bf16_t* ACT = (bf16_t*)(ws + WS_ACT); float* TMP2 = (float*)(ws + WS_TMP2);

    nv::ada<<<dim3(6144 / 256, NB), 256, 0, stream>>>(c, w_ada, b_ada, ADA);
    nv::rowprep<<<M, 256, 0, stream>>>(x, pos, ADA, g_pre_mix, w_in, b_gates, XN, IL, FL, ROPE);
    for (int ch = 0; ch < 8; ++ch) {
        const int row0 = ch * 4096;
        nv::gemm<<<dim3((INW + 63) / 64, 4096 / 64), 256, 0, stream>>>(XN + (size_t)row0 * 1024, 1024, w_in, INW, out, INW, INW, 1024);
        nv::proj_epi<<<(unsigned)(((size_t)4096 * INW + 255) / 256), 256, 0, stream>>>(out, row0, 4096, ROPE, QA, KA, VAT, QM, KM, KMT, VMT, OMS, GR, GM);
    }
    nv::attn<<<M * 8 / 4, 256, 0, stream>>>(QA, KA, VAT, sinks, AM);
    nv::mlstm<<<NB * 4, 128, 0, stream>>>(QM, KM, VMT, IL, FL, OMS, g_mlstm, AM);
    for (int ch = 0; ch < 2; ++ch) {
        const int row0 = ch * 16384; float* T1 = out; float* T2 = out + (size_t)16384 * 1024;
        nv::gemm<<<dim3(1024 / 64, 16384 / 64), 256, 0, stream>>>(AM + (size_t)row0 * 1024, 1024, w_att_o, 1024, T1, 1024, 1024, 512);
        nv::gemm<<<dim3(1024 / 64, 16384 / 64), 256, 0, stream>>>(AM + (size_t)row0 * 1024 + 512, 1024, w_ml_o, 1024, T2, 1024, 1024, 512);
        nv::merge_epi<<<16384 * 1024 / 256, 256, 0, stream>>>(T1, T2, row0, 16384, GR, GM, MERGED);
    }
    nv::gemm<<<dim3(1024 / 64, M / 64), 256, 0, stream>>>(MERGED, 1024, w_out, 1024, out, 1024, 1024, 1024);
    nv::postmix<<<M, 256, 0, stream>>>(x, out, ADA, g_post_mix, g_pre_ffn, XN);
    for (int ch = 0; ch < 8; ++ch) {
        const int row0 = ch * 4096;
        nv::gemm<<<dim3(2 * DFF / 64, 4096 / 64), 256, 0, stream>>>(XN + (size_t)row0 * 1024, 1024, w_ffn_in, 2 * DFF, TMP2, 2 * DFF, 2 * DFF, 1024);
        nv::ffn_act<<<(unsigned)(((size_t)4096 * DFF + 255) / 256), 256, 0, stream>>>(TMP2, row0, 4096, ACT);
    }
    nv::gemm<<<dim3(1024 / 64, M / 64), 256, 0, stream>>>(ACT, DFF, w_ffn_out, 1024, TMP2, 1024, 1024, DFF);
    nv::final_row<<<M, 256, 0, stream>>>(TMP2, out, ADA, g_post_ffn);
}
```
